# Optimizing an MI355X kernel written in HIP

```python
import math
import jax, jax.numpy as jnp
from jax import lax
import numpy as np

D_MODEL = 1024
BATCH = 2
SEQ = 8192
DEPTH = 1
DEC_BATCH = 8
DEC_SEQ = 32
PAST_LEN = 1024

CHUNK = 64
H_A = 4
HD_A = 64
W_A = H_A * 2 * HD_A
H_B = 8
HD_B = 64
W_B = H_B * HD_B
BAND_CHUNKS = 8
BAND_PAST = BAND_CHUNKS * CHUNK
REL_CLIP_B = 128
T5_BUCKETS = 32
T5_MAX_EXACT = 8
T5_MAX_DIST = 128
Q_BLOCK = 128
EPS = 1e-6
NEG = -1e30
IN_COLS = 4 * W_A + 4 * W_B + 2 * D_MODEL
SPLITS = [W_A, 2 * W_A, 3 * W_A, 4 * W_A, 4 * W_A + W_B, 4 * W_A + 2 * W_B, 4 * W_A + 3 * W_B, 4 * W_A + 4 * W_B]

kernel_name = 'hybrid_diffattn_chunkband_stream_step'


def rms_norm(x, g):
    xf = x.astype(jnp.float32)
    y = xf * lax.rsqrt(jnp.mean(xf * xf, axis=-1, keepdims=True) + EPS)
    return (y * g.astype(jnp.float32)).astype(x.dtype)


def t5_bucket(rel):
    half = T5_BUCKETS // 2
    ret = jnp.where(rel > 0, half, 0)
    n = jnp.abs(rel)
    nf = jnp.maximum(n, 1).astype(jnp.float32)
    large = T5_MAX_EXACT + (jnp.log(nf / T5_MAX_EXACT) / math.log(T5_MAX_DIST / T5_MAX_EXACT) * (half - T5_MAX_EXACT)).astype(jnp.int32)
    large = jnp.minimum(large, half - 1)
    return ret + jnp.where(n < T5_MAX_EXACT, n, large)


def diff_attn(q, k, v, qpos, kpos, t5_bias, lam, g_subln, lam_init):
    logits = jnp.einsum('bqhmd,bkhmd->bmhqk', q, k).astype(jnp.float32) * (HD_A ** -0.5)
    bias = jnp.transpose(t5_bias[t5_bucket(kpos[None, :] - qpos[:, None])], (2, 0, 1)).astype(jnp.float32)
    visible = (kpos[None, :] // CHUNK) <= (qpos[:, None] // CHUNK)
    p = jax.nn.softmax(jnp.where(visible, logits + bias, NEG), axis=-1)
    w = (p[:, 0] - lam * p[:, 1]).astype(v.dtype)
    o = jnp.einsum('bhqk,bkhe->bqhe', w, v)
    return rms_norm(o, g_subln) * (1.0 - lam_init)


def band_attn(q, k, v, qpos, kpos, rel_bias):
    logits = jnp.einsum('bnqhd,bnkhd->bnhqk', q, k).astype(jnp.float32) * (HD_B ** -0.5)
    rel = kpos[:, None, :] - qpos[:, :, None]
    bias = jnp.transpose(rel_bias[jnp.clip(rel, -REL_CLIP_B, REL_CLIP_B) + REL_CLIP_B], (0, 3, 1, 2)).astype(jnp.float32)
    qc = (qpos // CHUNK)[:, :, None]
    kc = (kpos // CHUNK)[:, None, :]
    visible = (kpos[:, None, :] >= 0) & (kc <= qc) & (kc >= qc - BAND_CHUNKS)
    p = jax.nn.softmax(jnp.where(visible[:, None], logits + bias, NEG), axis=-1)
    return jnp.einsum('bnhqk,bnkhd->bnqhd', p.astype(v.dtype), v)


def modulate_and_project(x, c, g_norm, w_ada, b_ada, w_in, g_qa, g_ka, g_qb, g_kb):
    B, T = x.shape[0], x.shape[1]
    mod = jax.nn.silu(c) @ w_ada + b_ada
    shift, scale, gate = jnp.split(mod, 3, axis=-1)
    h = rms_norm(x, g_norm) * (1.0 + scale[:, None]) + shift[:, None]
    qa, ka, va, ga, qb, kb, vb, gb, mg = jnp.split(h @ w_in, SPLITS, axis=-1)
    qa = rms_norm(qa.reshape(B, T, H_A, 2, HD_A), g_qa)
    ka = rms_norm(ka.reshape(B, T, H_A, 2, HD_A), g_ka)
    va = va.reshape(B, T, H_A, 2 * HD_A)
    qb = rms_norm(qb.reshape(B, T, H_B, HD_B), g_qb)
    kb = rms_norm(kb.reshape(B, T, H_B, HD_B), g_kb)
    vb = vb.reshape(B, T, H_B, HD_B)
    return gate, qa, ka, va, ga, qb, kb, vb, gb, mg


def merge_output(x, gate, oa, ga, ob, gb, mg, w_oa, w_ob, w_out):
    ya = (oa * jax.nn.silu(ga)) @ w_oa
    yb = (ob * jax.nn.silu(gb)) @ w_ob
    mga, mgb = jnp.split(mg, 2, axis=-1)
    m = jax.nn.sigmoid(mga) * ya + jax.nn.sigmoid(mgb) * yb
    return x + gate[:, None] * (m @ w_out)


def diff_attn_prompt(qa, ka, va, t5_bias, lam, g_subln, lam_init):
    B, S = qa.shape[0], qa.shape[1]
    nb = S // Q_BLOCK
    qblocks = jnp.moveaxis(qa.reshape(B, nb, Q_BLOCK, H_A, 2, HD_A), 1, 0)
    kpos = jnp.arange(S)

    def one_block(args):
        qi, i = args
        qpos = i * Q_BLOCK + jnp.arange(Q_BLOCK)
        return diff_attn(qi, ka, va, qpos, kpos, t5_bias, lam, g_subln, lam_init)

    o = lax.map(one_block, (qblocks, jnp.arange(nb)))
    return jnp.moveaxis(o, 0, 1).reshape(B, S, W_A)


def band_attn_prompt(qb, kb, vb, rel_bias):
    B, S = qb.shape[0], qb.shape[1]
    nc = S // CHUNK
    pad = ((0, 0), (BAND_CHUNKS, 0), (0, 0), (0, 0), (0, 0))
    kp = jnp.pad(kb.reshape(B, nc, CHUNK, H_B, HD_B), pad)
    vp = jnp.pad(vb.reshape(B, nc, CHUNK, H_B, HD_B), pad)
    idx = jnp.arange(nc)[:, None] + jnp.arange(BAND_CHUNKS + 1)[None, :]
    band_len = (BAND_CHUNKS + 1) * CHUNK
    kband = kp[:, idx].reshape(B, nc, band_len, H_B, HD_B)
    vband = vp[:, idx].reshape(B, nc, band_len, H_B, HD_B)
    kpos = ((idx - BAND_CHUNKS)[:, :, None] * CHUNK + jnp.arange(CHUNK)[None, None, :]).reshape(nc, band_len)
    qpos = jnp.arange(nc)[:, None] * CHUNK + jnp.arange(CHUNK)[None, :]
    o = band_attn(qb.reshape(B, nc, CHUNK, H_B, HD_B), kband, vband, qpos, kpos, rel_bias)
    return o.reshape(B, S, W_B)


def setup_inputs(seed: int = 0) -> dict:
    key = jax.random.key(seed)
    ks = jax.random.split(key, 32)
    f32 = jnp.float32
    nrm = lambda k, shp, s: jax.random.normal(k, shp, f32) * s
    lb = min(BAND_PAST, PAST_LEN)
    return {
        'x_prompt': nrm(ks[0], (BATCH, SEQ, D_MODEL), 1.0),
        'x_sample': nrm(ks[1], (DEC_BATCH, DEC_SEQ, D_MODEL), 1.0),
        'cache_a_k': nrm(ks[2], (DEPTH, DEC_BATCH, PAST_LEN, H_A, 2 * HD_A), 1.0),
        'cache_a_v': nrm(ks[3], (DEPTH, DEC_BATCH, PAST_LEN, H_A, 2 * HD_A), 1.0),
        'cache_b_k': nrm(ks[4], (DEPTH, DEC_BATCH, lb, H_B, HD_B), 1.0),
        'cache_b_v': nrm(ks[5], (DEPTH, DEC_BATCH, lb, H_B, HD_B), 1.0),
        'c_prompt': nrm(ks[6], (BATCH, D_MODEL), 1.0),
        'c_sample': nrm(ks[7], (DEC_BATCH, D_MODEL), 1.0),
        'g_norm': 1.0 + nrm(ks[8], (DEPTH, D_MODEL), 0.01),
        'w_ada': nrm(ks[9], (DEPTH, D_MODEL, 3 * D_MODEL), 0.5 * D_MODEL ** -0.5),
        'b_ada': nrm(ks[10], (DEPTH, 3 * D_MODEL), 0.01),
        'w_in': nrm(ks[11], (DEPTH, D_MODEL, IN_COLS), D_MODEL ** -0.5),
        'g_qa': 1.0 + nrm(ks[12], (DEPTH, HD_A), 0.01),
        'g_ka': 1.0 + nrm(ks[13], (DEPTH, HD_A), 0.01),
        'lam_q1': nrm(ks[14], (DEPTH, HD_A), 0.1),
        'lam_k1': nrm(ks[15], (DEPTH, HD_A), 0.1),
        'lam_q2': nrm(ks[16], (DEPTH, HD_A), 0.1),
        'lam_k2': nrm(ks[17], (DEPTH, HD_A), 0.1),
        'g_subln': 1.0 + nrm(ks[18], (DEPTH, 2 * HD_A), 0.01),
        't5_bias': nrm(ks[19], (T5_BUCKETS, H_A), 0.1),
        'g_qb': 1.0 + nrm(ks[20], (DEPTH, HD_B), 0.01),
        'g_kb': 1.0 + nrm(ks[21], (DEPTH, HD_B), 0.01),
        'rel_bias_b': nrm(ks[22], (DEPTH, 2 * REL_CLIP_B + 1, H_B), 0.1),
        'w_oa': nrm(ks[23], (DEPTH, W_A, D_MODEL), W_A ** -0.5),
        'w_ob': nrm(ks[24], (DEPTH, W_B, D_MODEL), W_B ** -0.5),
        'w_out': nrm(ks[25], (DEPTH, D_MODEL, D_MODEL), D_MODEL ** -0.5),
    }


def reference(x_prompt, x_sample, cache_a_k, cache_a_v, cache_b_k, cache_b_v, c_prompt, c_sample, g_norm, w_ada, b_ada, w_in, g_qa, g_ka, lam_q1, lam_k1, lam_q2, lam_k2, g_subln, t5_bias, g_qb, g_kb, rel_bias_b, w_oa, w_ob, w_out):
    xp, xs = x_prompt, x_sample
    BP, S = xp.shape[0], xp.shape[1]
    BS, T = xs.shape[0], xs.shape[1]
    past_len = cache_a_k.shape[2]
    n_keep = min(BAND_PAST, S)
    akp, avp, bkp, bvp, aks, avs, bks, bvs = [], [], [], [], [], [], [], []
    for l in range(DEPTH):
        lam_init = 0.8 - 0.6 * math.exp(-0.3 * l)
        lam = (jnp.exp(jnp.sum((lam_q1[l] * lam_k1[l]).astype(jnp.float32)))
               - jnp.exp(jnp.sum((lam_q2[l] * lam_k2[l]).astype(jnp.float32))) + lam_init)
        proj = (g_norm[l], w_ada[l], b_ada[l], w_in[l], g_qa[l], g_ka[l], g_qb[l], g_kb[l])
        outp = (w_oa[l], w_ob[l], w_out[l])

        gate, qa, ka, va, ga, qb, kb, vb, gb, mg = modulate_and_project(xp, c_prompt, *proj)
        oa = diff_attn_prompt(qa, ka, va, t5_bias, lam, g_subln[l], lam_init)
        ob = band_attn_prompt(qb, kb, vb, rel_bias_b[l])
        xp = merge_output(xp, gate, oa, ga, ob, gb, mg, *outp)
        akp.append(ka.reshape(BP, S, H_A, 2 * HD_A))
        avp.append(va)
        bkp.append(kb[:, S - n_keep:])
        bvp.append(vb[:, S - n_keep:])

        gate, qa, ka, va, ga, qb, kb, vb, gb, mg = modulate_and_project(xs, c_sample, *proj)
        k_all = jnp.concatenate([cache_a_k[l].reshape(BS, past_len, H_A, 2, HD_A), ka], axis=1)
        v_all = jnp.concatenate([cache_a_v[l], va], axis=1)
        qpos = past_len + jnp.arange(T)
        kpos = jnp.arange(past_len + T)
        oa = diff_attn(qa, k_all, v_all, qpos, kpos, t5_bias, lam, g_subln[l], lam_init).reshape(BS, T, W_A)
        lb = cache_b_k.shape[2]
        kb_all = jnp.concatenate([cache_b_k[l], kb], axis=1)[:, None]
        vb_all = jnp.concatenate([cache_b_v[l], vb], axis=1)[:, None]
        kpos_b = jnp.concatenate([past_len - lb + jnp.arange(lb), qpos])[None]
        ob = band_attn(qb[:, None], kb_all, vb_all, qpos[None], kpos_b, rel_bias_b[l]).reshape(BS, T, W_B)
        xs = merge_output(xs, gate, oa, ga, ob, gb, mg, *outp)
        aks.append(ka.reshape(BS, T, H_A, 2 * HD_A))
        avs.append(va)
        bks.append(kb)
        bvs.append(vb)

    return (xp, xs, jnp.stack(akp), jnp.stack(avp), jnp.stack(bkp), jnp.stack(bvp), jnp.stack(aks), jnp.stack(avs), jnp.stack(bks), jnp.stack(bvs))
```

```cpp
#include <hip/hip_runtime.h>
#include <cstdio>
#include <cstdint>
#define MK_N_LAUNCHES 1
namespace pg8 {
#define PG8_LAS __attribute__((address_space(3)))
typedef unsigned short bf16_t;
typedef short bf16x8 __attribute__((ext_vector_type(8)));
typedef float f32x4 __attribute__((ext_vector_type(4)));
typedef unsigned u32x4 __attribute__((ext_vector_type(4)));
constexpr int BM = 256, BK = 64, HALF = 128, HTB = HALF * BK * 2  , STAGE_BYTES = 8 * HTB, NXCD = 8, WGM = 8;

__host__ __device__ __forceinline__ int lds_byte(int r, int c) { const int st = (r >> 4) * 2 + (c >> 5), rr = r & 15, cc = c & 31, ob = rr * 64 + cc * 2; return st * 1024 + (ob ^ (((ob >> 9) & 1) << 5)); }
__host__ __device__ __forceinline__ void stage_rc(int b, int& R, int& C) { const int st = b / 1024, sb = b % 1024, swz = sb ^ (((sb >> 9) & 1) << 5); R = (st >> 1) * 16 + swz / 64; C = (st & 1) * 32 + (swz % 64) / 2; }
__host__ __device__ __forceinline__ int perm32(int rho) { const int n = rho >> 4, i = rho & 15; return 8 * (i >> 2) + 4 * n + (i & 3); }

struct Unit { int pm, pn; };
struct Gemm { const bf16_t* A; const bf16_t* Bt; int M, N, K; };

struct StaticOrder {
    int nM, nN, nwg, G, c;
    __host__ __device__ void init(int M, int N, int G_, int c_) { nM = M / BM; nN = N / BM; nwg = nM * nN; G = G_; c = c_; }
    __host__ __device__ bool next(int i, Unit& u) const {
        const long L = (long)i * G + c; if (L >= nwg) return false;
        int wgid = (int)L; { const int q = nwg / NXCD, r = nwg % NXCD, xcd = wgid % NXCD, off = wgid / NXCD; wgid = (xcd < r ? xcd * (q + 1) : r * (q + 1) + (xcd - r) * q) + off; }
        const int nig = WGM * nN, gid = wgid / nig, fm = gid * WGM, gsz = (nM - fm) < WGM ? (nM - fm) : WGM;
        u.pm = fm + ((wgid % nig) % gsz); u.pn = (wgid % nig) / gsz; return true;
    }
    __device__ __forceinline__ void a_ready(const Unit&) const {}
    __device__ __forceinline__ void done(const Unit&) const {}
};

template <class Epi, class Sched, bool ALIGN_EPI = false, bool SP2 = false>
__device__ __forceinline__ void gemm_phase(PG8_LAS unsigned char* lds, const Gemm g, const Sched& S, const Epi& E) {
    const int tid = threadIdx.x, wid = __builtin_amdgcn_readfirstlane(tid >> 6), lane = tid & 63, wr = wid >> 2, wc = wid & 3, fr = lane & 15, fq = lane >> 4;
    const int K = g.K, nt = K / BK;
    unsigned voffA[2], voffB[2];
#pragma unroll
    for (int i = 0; i < 2; ++i) { int R, C; stage_rc(tid * 16 + i * 8192, R, C); const int Rb = Epi::PERM ? ((R & ~31) + perm32(R & 31)) : R;
        voffA[i] = (unsigned)(R * K + C) * 2u; voffB[i] = (unsigned)(Rb * K + C) * 2u; }
    const size_t kstep = (size_t)(BK * 2);
    const size_t hstep = (size_t)HALF * K * 2;
    const size_t tstep = 2 * hstep;
    const unsigned ldsw = (unsigned)wid * 1024u;
    const int aoff = lds_byte(wr * 64 + fr, fq * 8), boff = lds_byte(wc * 32 + fr, fq * 8);
#define PG8_SA(b, h) (((b) * 2 + (h)) * HTB)
#define PG8_SB(b, h) ((4 + (b) * 2 + (h)) * HTB)
#define PG8_STAGE(bufoff, gbase, voff) do { _Pragma("unroll") for (int _i = 0; _i < 2; ++_i) \
        __builtin_amdgcn_global_load_lds((const unsigned*)((const char*)(gbase) + (voff)[_i]), (PG8_LAS unsigned*)(lds + (bufoff) + ldsw + _i * 8192), 16, 0, 0); } while (0)
#define PG8_LDA(dst, b, h) do { _Pragma("unroll") for (int m = 0; m < 4; ++m) _Pragma("unroll") for (int k = 0; k < 2; ++k) dst[m][k] = *(const PG8_LAS bf16x8*)(lds + PG8_SA(b, h) + aoff + m * 2048 + k * 1024); } while (0)
#define PG8_LDB(dst, b, h) do { _Pragma("unroll") for (int n = 0; n < 2; ++n) _Pragma("unroll") for (int k = 0; k < 2; ++k) dst[n][k] = *(const PG8_LAS bf16x8*)(lds + PG8_SB(b, h) + boff + n * 2048 + k * 1024); } while (0)
#define PG8_MMA(ai, bj, At, Bt) do { __builtin_amdgcn_s_setprio(1); _Pragma("unroll") for (int m = 0; m < 4; ++m) _Pragma("unroll") for (int n = 0; n < 2; ++n) _Pragma("unroll") for (int k = 0; k < 2; ++k) \
        acc[ai][bj][m][n] = __builtin_amdgcn_mfma_f32_16x16x32_bf16(Bt[n][k], At[m][k], acc[ai][bj][m][n], 0, 0, 0); __builtin_amdgcn_s_setprio(0); } while (0)
#define PG8_WAIT_V(n) asm volatile("s_waitcnt vmcnt(" #n ")" ::: "memory")
#define PG8_WAIT_L(n) asm volatile("s_waitcnt lgkmcnt(" #n ")" ::: "memory")
#define PG8_BAR __builtin_amdgcn_s_barrier()
#define PG8_SCHED __builtin_amdgcn_sched_barrier(0)
    Unit cur, nxt; int ui = 0;
    if (!S.next(0, cur)) return;
    f32x4 acc[2][2][4][2];
#pragma unroll
    for (int a = 0; a < 2; ++a)
#pragma unroll
        for (int b = 0; b < 2; ++b)
#pragma unroll
            for (int m = 0; m < 4; ++m)
#pragma unroll
                for (int n = 0; n < 2; ++n) acc[a][b][m][n] = (f32x4){0.f, 0.f, 0.f, 0.f};
    bf16x8 At[4][2], B0[2][2], B1[2][2];
    const char* cA = (const char*)g.A + (size_t)cur.pm * tstep; const char* cB = (const char*)g.Bt + (size_t)cur.pn * tstep;
    S.a_ready(cur);
    if constexpr (SP2) {
        PG8_STAGE(PG8_SB(0, 0), cB, voffB); PG8_STAGE(PG8_SB(0, 1), cB + hstep, voffB); PG8_STAGE(PG8_SA(0, 0), cA, voffA); PG8_STAGE(PG8_SA(0, 1), cA + hstep, voffA);
        if (wr == 1) PG8_BAR;
        PG8_WAIT_V(2); PG8_BAR;
        PG8_STAGE(PG8_SB(1, 0), cB + kstep, voffB); PG8_STAGE(PG8_SA(1, 0), cA + kstep, voffA); PG8_STAGE(PG8_SB(1, 1), cB + hstep + kstep, voffB);
        PG8_WAIT_V(6); PG8_BAR;
    } else {
        PG8_STAGE(PG8_SB(0, 0), cB, voffB); PG8_STAGE(PG8_SA(0, 0), cA, voffA); PG8_STAGE(PG8_SB(0, 1), cB + hstep, voffB); PG8_STAGE(PG8_SA(0, 1), cA + hstep, voffA);
        if (wr == 1) PG8_BAR;
        PG8_WAIT_V(4); PG8_BAR;
        PG8_STAGE(PG8_SB(1, 0), cB + kstep, voffB); PG8_STAGE(PG8_SA(1, 0), cA + kstep, voffA); PG8_STAGE(PG8_SB(1, 1), cB + hstep + kstep, voffB);
        PG8_WAIT_V(6); PG8_BAR;
    }
    for (;;) {
        const bool has_next = S.next(ui + 1, nxt);
        const char* nA = has_next ? (const char*)g.A + (size_t)nxt.pm * tstep : cA; const char* nB = has_next ? (const char*)g.Bt + (size_t)nxt.pn * tstep : cB;
        for (int t = 0; t < nt; t += 2) {
            const bool last = (t == nt - 2);
            const char* a1 = cA + (size_t)(t + 1) * kstep;
            const char* a2 = last ? nA : cA + (size_t)(t + 2) * kstep; const char* b2 = last ? nB : cB + (size_t)(t + 2) * kstep;
            const char* a3 = a2 + kstep; const char* b3 = b2 + kstep;
            if (last && has_next) S.a_ready(nxt);
            if constexpr (SP2) {
            PG8_LDB(B0, 0, 0); PG8_LDB(B1, 0, 1); PG8_SCHED; PG8_LDA(At, 0, 0); PG8_STAGE(PG8_SA(1, 1), a1 + hstep, voffA);
            PG8_WAIT_V(8); PG8_WAIT_L(0); PG8_BAR; PG8_MMA(0, 0, At, B0); PG8_MMA(0, 1, At, B1); PG8_BAR; PG8_SCHED;
            PG8_LDA(At, 0, 1); PG8_STAGE(PG8_SB(0, 0), b2, voffB); PG8_STAGE(PG8_SB(0, 1), b2 + hstep, voffB); PG8_STAGE(PG8_SA(0, 0), a2, voffA);
            PG8_WAIT_V(8); PG8_WAIT_L(0); PG8_BAR; PG8_MMA(1, 0, At, B0); PG8_MMA(1, 1, At, B1); PG8_BAR; PG8_SCHED;
            PG8_LDB(B0, 1, 0); PG8_LDB(B1, 1, 1); PG8_SCHED; PG8_LDA(At, 1, 0); PG8_STAGE(PG8_SA(0, 1), a2 + hstep, voffA);
            PG8_WAIT_V(8); PG8_WAIT_L(0); PG8_BAR; PG8_MMA(0, 0, At, B0); PG8_MMA(0, 1, At, B1); PG8_BAR; PG8_SCHED;
            PG8_LDA(At, 1, 1); PG8_STAGE(PG8_SB(1, 0), b3, voffB); PG8_STAGE(PG8_SB(1, 1), b3 + hstep, voffB); PG8_STAGE(PG8_SA(1, 0), a3, voffA);
            PG8_WAIT_V(8); PG8_WAIT_L(0); PG8_BAR; PG8_MMA(1, 0, At, B0); PG8_MMA(1, 1, At, B1); PG8_BAR; PG8_SCHED;
            } else {
            PG8_LDB(B0, 0, 0); PG8_SCHED; PG8_LDA(At, 0, 0); PG8_STAGE(PG8_SA(1, 1), a1 + hstep, voffA);
            PG8_WAIT_L(8); PG8_BAR; PG8_WAIT_L(0); PG8_MMA(0, 0, At, B0); PG8_BAR; PG8_SCHED;
            PG8_LDB(B1, 0, 1); PG8_STAGE(PG8_SB(0, 0), b2, voffB);
            PG8_BAR; PG8_WAIT_L(0); PG8_MMA(0, 1, At, B1); PG8_BAR;
            PG8_LDA(At, 0, 1); PG8_STAGE(PG8_SA(0, 0), a2, voffA);
            PG8_BAR; PG8_WAIT_L(0); PG8_MMA(1, 0, At, B0); PG8_BAR; PG8_SCHED;
            PG8_STAGE(PG8_SB(0, 1), b2 + hstep, voffB);
            PG8_WAIT_V(6); PG8_BAR; PG8_MMA(1, 1, At, B1); PG8_BAR;
            PG8_LDB(B0, 1, 0); PG8_SCHED; PG8_LDA(At, 1, 0); PG8_STAGE(PG8_SA(0, 1), a2 + hstep, voffA);
            PG8_WAIT_L(8); PG8_BAR; PG8_WAIT_L(0); PG8_MMA(0, 0, At, B0); PG8_BAR; PG8_SCHED;
            PG8_LDB(B1, 1, 1); PG8_STAGE(PG8_SB(1, 0), b3, voffB);
            PG8_BAR; PG8_WAIT_L(0); PG8_MMA(0, 1, At, B1); PG8_BAR;
            PG8_LDA(At, 1, 1); PG8_STAGE(PG8_SA(1, 0), a3, voffA);
            PG8_BAR; PG8_WAIT_L(0); PG8_MMA(1, 0, At, B0); PG8_BAR; PG8_SCHED;
            PG8_STAGE(PG8_SB(1, 1), b3 + hstep, voffB);
            PG8_WAIT_V(6); PG8_BAR; PG8_MMA(1, 1, At, B1); PG8_BAR;
            }
        }
        if constexpr (ALIGN_EPI) { if (wr == 0) PG8_BAR; }
        if constexpr (!Epi::AFTER_DRAIN) { E(acc, cur, wr, wc, fr, fq); S.done(cur); }
        if (!has_next) break;
#pragma unroll
        for (int a = 0; a < 2; ++a)
#pragma unroll
            for (int b = 0; b < 2; ++b)
#pragma unroll
                for (int m = 0; m < 4; ++m)
#pragma unroll
                    for (int n = 0; n < 2; ++n) acc[a][b][m][n] = (f32x4){0.f, 0.f, 0.f, 0.f};
        cur = nxt; cA = nA; cB = nB; ++ui;
        if constexpr (ALIGN_EPI) { if (wr == 1) PG8_BAR; }
    }
    PG8_WAIT_V(0);
    if constexpr (!ALIGN_EPI) { if (wr == 0) PG8_BAR; }
    PG8_BAR;
    if constexpr (Epi::AFTER_DRAIN) { E.fused(acc, cur, wr, wc, fr, fq, lds, wid, lane); S.done(cur); }
#undef PG8_SA
#undef PG8_SB
#undef PG8_STAGE
#undef PG8_LDA
#undef PG8_LDB
#undef PG8_MMA
#undef PG8_WAIT_V
#undef PG8_WAIT_L
#undef PG8_BAR
#undef PG8_SCHED
}
}

#define GAS __attribute__((address_space(1)))
#define LAS __attribute__((address_space(3)))
typedef unsigned short bf16_t;
typedef short bf16x8 __attribute__((ext_vector_type(8)));
typedef float f32x4 __attribute__((ext_vector_type(4)));
typedef float f32x16 __attribute__((ext_vector_type(16)));
typedef unsigned u32x4 __attribute__((ext_vector_type(4)));
typedef unsigned u32x2 __attribute__((ext_vector_type(2)));
typedef float f32x2_t __attribute__((ext_vector_type(2)));
typedef __bf16 bf16x2_t __attribute__((ext_vector_type(2)));

constexpr int NWAVES = 8;
constexpr int DM = 1024, SEQ = 8192, MP = 2 * SEQ, MS = 256, INC = 6144;
constexpr float EPS = 1e-6f, LOG2E = 1.4426950408889634f, C2 = 0.125f * 1.4426950408889634f, LAM_INIT = 0.2f;
constexpr size_t MiB = 1u << 20;
constexpr size_t WS_CTL = 0, CTL_ZERO_BYTES = 1 * MiB;
constexpr size_t WS_MODP = 1 * MiB, WS_MODF = 1 * MiB + 512 * 1024;
constexpr size_t WS_WIN = 2 * MiB, WS_WOA = 14 * MiB, WS_WOB = 15 * MiB, WS_WOUT = 16 * MiB, WS_MGS = 18 * MiB;
constexpr size_t WS_XN = 20 * MiB, WS_OGA = 20 * MiB, WS_OGB = 20 * MiB + 16 * MiB + 512 * 1024;
constexpr size_t WS_Q = 53 * MiB, WS_MT = 53 * MiB, WS_G = 86 * MiB;
constexpr size_t WS_RAP = 119 * MiB, WS_RBP = 151 * MiB, WS_RAS = 183 * MiB, WS_RBS = 200 * MiB, WS_END = 209 * MiB;
constexpr int RECA = 32768, RECB = 16384;
constexpr int CW_BAR = 4096;
constexpr size_t O_YP = 0, O_YS = 16777216, O_AKP = 17039360, O_AVP = 25427968, O_BKP = 33816576, O_BVP = 34340864,
                 O_AKS = 34865152, O_AVS = 34996224, O_BKS = 35127296, O_BVS = 35258368, O_END = 35389440;
constexpr int RING_OFF = 0, RING_BYTES = 131072, MISC_OFF = RING_BYTES + 320, LDS_BYTES = 147456;
constexpr int TAB_OFF = 65536;

#define LDS_WAIT() asm volatile("s_waitcnt lgkmcnt(0)" ::: "memory")
#define VM_WAIT() asm volatile("s_waitcnt vmcnt(0)" ::: "memory")

__device__ __forceinline__ unsigned pk2(float lo, float hi) { f32x2_t v = {lo, hi}; bf16x2_t b = __builtin_convertvector(v, bf16x2_t); return __builtin_bit_cast(unsigned, b); }
__device__ __forceinline__ bf16_t f2bf(float f) { return (bf16_t)(pk2(f, 0.f) & 0xffffu); }
__device__ __forceinline__ float bf2f(unsigned short h) { return __builtin_bit_cast(float, (unsigned)h << 16); }
__device__ __forceinline__ u32x4 pack8(const float (&v)[8]) { u32x4 w; w.x = pk2(v[0], v[1]); w.y = pk2(v[2], v[3]); w.z = pk2(v[4], v[5]); w.w = pk2(v[6], v[7]); return w; }
__device__ __forceinline__ void unpack8(u32x4 w, float (&v)[8]) {
    v[0] = __builtin_bit_cast(float, w.x << 16); v[1] = __builtin_bit_cast(float, w.x & 0xffff0000u);
    v[2] = __builtin_bit_cast(float, w.y << 16); v[3] = __builtin_bit_cast(float, w.y & 0xffff0000u);
    v[4] = __builtin_bit_cast(float, w.z << 16); v[5] = __builtin_bit_cast(float, w.z & 0xffff0000u);
    v[6] = __builtin_bit_cast(float, w.w << 16); v[7] = __builtin_bit_cast(float, w.w & 0xffff0000u);
}
__device__ __forceinline__ float sigmoidf_(float x) { return __builtin_amdgcn_rcpf(1.f + __builtin_amdgcn_exp2f(-x * LOG2E)); }
__device__ __forceinline__ float siluf_(float x) { return x * sigmoidf_(x); }
__device__ __forceinline__ int crow(int r, int hi) { return (r & 3) + 8 * (r >> 2) + 4 * hi; }

struct Ctx {
    const float *xp, *xs, *cak, *cav, *cbk, *cbv, *cp, *cs, *g_norm, *w_ada, *b_ada, *w_in, *g_qa, *g_ka, *lq1, *lk1, *lq2, *lk2, *g_sub, *t5, *g_qb, *g_kb, *relb, *w_oa, *w_ob, *w_out;
    float* out; unsigned char* ws;
    int G, bx, vcu, tid, lane, wave;
};

template <int T, bool SMP>
__device__ __forceinline__ void emit8(const Ctx& C, int row, int gl, int ch, const float (&vin)[8], float rs) {
    float v[8];
    const int rsamp = row - MP, bs = rsamp >> 5, si = rsamp & 31;
    const int b = row >> 13, s = row & 8191;
    if (T == 0 || T == 1 || T == 4 || T == 5) {
        const float* g = (T == 0) ? C.g_qa : (T == 1) ? C.g_ka : (T == 4) ? C.g_qb : C.g_kb;
        const f32x4 g0 = *(const f32x4*)(g + ch * 8), g1 = *(const f32x4*)(g + ch * 8 + 4);
        const float sc = (T == 0 || T == 4) ? rs * C2 : rs;
        v[0] = vin[0] * sc * g0[0]; v[1] = vin[1] * sc * g0[1]; v[2] = vin[2] * sc * g0[2]; v[3] = vin[3] * sc * g0[3];
        v[4] = vin[4] * sc * g1[0]; v[5] = vin[5] * sc * g1[1]; v[6] = vin[6] * sc * g1[2]; v[7] = vin[7] * sc * g1[3];
    } else if (T == 3 || T == 7) {
#pragma unroll
        for (int e = 0; e < 8; ++e) v[e] = siluf_(vin[e]);
    } else if (T == 8) {
#pragma unroll
        for (int e = 0; e < 8; ++e) v[e] = sigmoidf_(vin[e]);
    } else {
#pragma unroll
        for (int e = 0; e < 8; ++e) v[e] = vin[e];
    }
    if (T == 0 || T == 4) { bf16_t* q = (bf16_t*)(C.ws + WS_Q) + (size_t)row * 1024 + (T == 4 ? 512 : 0) + gl * 64 + ch * 8; *(u32x4*)q = pack8(v); }
    if (T == 3 || T == 7) { bf16_t* q = (bf16_t*)(C.ws + WS_G) + (size_t)row * 1024 + (T == 7 ? 512 : 0) + gl * 64 + ch * 8; *(u32x4*)q = pack8(v); }
    if (T == 8) {
        bf16_t* q = SMP ? (bf16_t*)(C.ws + WS_MGS) + (size_t)rsamp * 2048 + gl * 64 + ch * 8 : (bf16_t*)(C.out + O_YP) + (size_t)row * 2048 + gl * 64 + ch * 8;
        *(u32x4*)q = pack8(v);
    }
    if (T == 1 || T == 2) {
        float* o = SMP ? C.out + (T == 1 ? O_AKS : O_AVS) + (size_t)rsamp * 512 : C.out + (T == 1 ? O_AKP : O_AVP) + (size_t)row * 512;
        o += gl * 64 + ch * 8;
        *(f32x4*)o = (f32x4){v[0], v[1], v[2], v[3]}; *(f32x4*)(o + 4) = (f32x4){v[4], v[5], v[6], v[7]};
        const int h = gl >> 1, mp = gl & 1;
        unsigned char* rec = SMP ? C.ws + WS_RAS + (size_t)((bs * 4 + h) * 17 + 16) * RECA : C.ws + WS_RAP + (size_t)((b * 4 + h) * 128 + (s >> 6)) * RECA;
        const int key = SMP ? si : (s & 63);
        if (T == 1) { *(u32x4*)(rec + mp * 8192 + ch * 1024 + key * 16) = pack8(v); }
        else { unsigned char* p = rec + 16384 + (key >> 3) * 2048 + (key & 7) * 2 + (mp * 64 + ch * 8) * 16;
#pragma unroll
            for (int e = 0; e < 8; ++e) *(bf16_t*)(p + e * 16) = f2bf(v[e]); }
    }
    if (T == 5 || T == 6) {
        float* o = nullptr;
        if (SMP) o = C.out + (T == 5 ? O_BKS : O_BVS) + (size_t)rsamp * 512;
        else if (s >= SEQ - 512) o = C.out + (T == 5 ? O_BKP : O_BVP) + (size_t)(b * 512 + s - (SEQ - 512)) * 512;
        if (o) { o += gl * 64 + ch * 8; *(f32x4*)o = (f32x4){v[0], v[1], v[2], v[3]}; *(f32x4*)(o + 4) = (f32x4){v[4], v[5], v[6], v[7]}; }
        unsigned char* rec = SMP ? C.ws + WS_RBS + (size_t)((bs * 8 + gl) * 9 + 8) * RECB : C.ws + WS_RBP + (size_t)((b * 8 + gl) * 128 + (s >> 6)) * RECB;
        const int key = SMP ? si : (s & 63);
        if (T == 5) { *(u32x4*)(rec + ch * 1024 + key * 16) = pack8(v); }
        else { unsigned char* p = rec + 8192 + (key >> 3) * 1024 + (key & 7) * 2 + (ch * 8) * 16;
#pragma unroll
            for (int e = 0; e < 8; ++e) *(bf16_t*)(p + e * 16) = f2bf(v[e]); }
    }
}

struct EpiInProj {
    static constexpr bool PERM = true, AFTER_DRAIN = false;
    Ctx C;
    template <int T> __device__ __forceinline__ void run(const f32x4 (&acc)[2][2][4][2], const pg8::Unit& u, int wr, int wc, int fr, int fq, int gl) const {
#pragma unroll
        for (int ai = 0; ai < 2; ++ai)
#pragma unroll
            for (int m = 0; m < 4; ++m) {
                const int row = u.pm * 256 + ai * 128 + wr * 64 + m * 16 + fr;
                float v[2][8]; float ss = 0.f;
#pragma unroll
                for (int bj = 0; bj < 2; ++bj)
#pragma unroll
                    for (int n = 0; n < 2; ++n)
#pragma unroll
                        for (int e = 0; e < 4; ++e) { const float x = acc[ai][bj][m][n][e]; v[bj][4 * n + e] = x; ss += x * x; }
                float rs = 1.f;
                if (T == 0 || T == 1 || T == 4 || T == 5) { ss += __shfl_xor(ss, 16); ss += __shfl_xor(ss, 32); rs = __builtin_amdgcn_rsqf(ss * (1.f / 64.f) + EPS); }
#pragma unroll
                for (int bj = 0; bj < 2; ++bj) emit8<T, false>(C, row, gl, 4 * bj + fq, v[bj], rs);
            }
    }
    __device__ __forceinline__ void operator()(const f32x4 (&acc)[2][2][4][2], const pg8::Unit& u, int wr, int wc, int fr, int fq) const {
        asm volatile("" : "+v"(fr), "+v"(fq));
        const int G = u.pn * 4 + wc, sec = u.pn >> 1, gl = G & 7;
        switch (sec) {
            case 0: run<0>(acc, u, wr, wc, fr, fq, gl); break;
            case 1: run<1>(acc, u, wr, wc, fr, fq, gl); break;
            case 2: run<2>(acc, u, wr, wc, fr, fq, gl); break;
            case 3: run<3>(acc, u, wr, wc, fr, fq, gl); break;
            case 4: run<4>(acc, u, wr, wc, fr, fq, gl); break;
            case 5: run<5>(acc, u, wr, wc, fr, fq, gl); break;
            case 6: run<6>(acc, u, wr, wc, fr, fq, gl); break;
            case 7: run<7>(acc, u, wr, wc, fr, fq, gl); break;
            default: run<8>(acc, u, wr, wc, fr, fq, G - 64); break;
        }
    }
};
template <int STEP> struct EpiMerge {
    static constexpr bool PERM = true, AFTER_DRAIN = false;
    Ctx C;
    __device__ __forceinline__ void operator()(const f32x4 (&acc)[2][2][4][2], const pg8::Unit& u, int wr, int wc, int fr, int fq) const {
        asm volatile("" : "+v"(fr), "+v"(fq));
        const bf16_t* MG = (const bf16_t*)(C.out + O_YP); bf16_t* MTp = (bf16_t*)(C.ws + WS_MT);
#pragma unroll
        for (int ai = 0; ai < 2; ++ai)
#pragma unroll
            for (int m = 0; m < 4; ++m) {
                const int row = u.pm * 256 + ai * 128 + wr * 64 + m * 16 + fr;
#pragma unroll
                for (int bj = 0; bj < 2; ++bj) {
                    const int col = u.pn * 256 + bj * 128 + wc * 32 + fq * 8;
                    float g[8], v[8];
                    unpack8(*(const u32x4*)(MG + (size_t)row * 2048 + (STEP ? 1024 : 0) + col), g);
                    if (STEP) { float t[8]; unpack8(*(const u32x4*)(MTp + (size_t)row * 1024 + col), t);
#pragma unroll
                        for (int e = 0; e < 8; ++e) v[e] = t[e] + g[e] * acc[ai][bj][m][e >> 2][e & 3]; }
                    else {
#pragma unroll
                        for (int e = 0; e < 8; ++e) v[e] = g[e] * acc[ai][bj][m][e >> 2][e & 3]; }
                    *(u32x4*)(MTp + (size_t)row * 1024 + col) = pack8(v);
                }
            }
    }
};
struct EpiFinal {
    static constexpr bool PERM = true, AFTER_DRAIN = false;
    Ctx C;
    __device__ __forceinline__ void operator()(const f32x4 (&acc)[2][2][4][2], const pg8::Unit& u, int wr, int wc, int fr, int fq) const {
        asm volatile("" : "+v"(fr), "+v"(fq));
        const float* MODF = (const float*)(C.ws + WS_MODF);
#pragma unroll
        for (int ai = 0; ai < 2; ++ai)
#pragma unroll
            for (int m = 0; m < 4; ++m) {
                const int row = u.pm * 256 + ai * 128 + wr * 64 + m * 16 + fr; const int b = row >> 13;
#pragma unroll
                for (int bj = 0; bj < 2; ++bj) {
                    const int col = u.pn * 256 + bj * 128 + wc * 32 + fq * 8;
#pragma unroll
                    for (int n = 0; n < 2; ++n) {
                        const f32x4 gt = *(const f32x4*)(MODF + b * 3072 + 2048 + col + 4 * n);
                        const f32x4 xv = *(const f32x4*)(C.xp + (size_t)row * 1024 + col + 4 * n);
                        *(f32x4*)(C.out + O_YP + (size_t)row * 1024 + col + 4 * n) = xv + gt * acc[ai][bj][m][n];
                    }
                }
            }
    }
};

__device__ __forceinline__ void wave_gemm32x64(const bf16_t* A, int lda, const bf16_t* B0, const bf16_t* B1, int ldb, int K, f32x16 (&acc)[2], int lane) {
    const int j = lane & 31, hi = lane >> 5;
    const int pj = (j & ~12) | ((j & 4) << 1) | ((j & 8) >> 1);
    const bf16_t* ap = A + (size_t)j * lda + 8 * hi;
    const bf16_t* b0 = B0 + (size_t)pj * ldb + 8 * hi;
    const bf16_t* b1 = B1 + (size_t)pj * ldb + 8 * hi;
    for (int k = 0; k < K; k += 64) {
        bf16x8 a[4], w0[4], w1[4];
#pragma unroll
        for (int i = 0; i < 4; ++i) { a[i] = *(const bf16x8*)(ap + k + 16 * i); w0[i] = *(const bf16x8*)(b0 + k + 16 * i); w1[i] = *(const bf16x8*)(b1 + k + 16 * i); }
#pragma unroll
        for (int i = 0; i < 4; ++i) { acc[0] = __builtin_amdgcn_mfma_f32_32x32x16_bf16(w0[i], a[i], acc[0], 0, 0, 0); acc[1] = __builtin_amdgcn_mfma_f32_32x32x16_bf16(w1[i], a[i], acc[1], 0, 0, 0); }
    }
}
template <int T> __device__ __forceinline__ void smp_inproj_epi(const Ctx& C, const f32x16 (&acc)[2], int row, int gl, int hi) {
    float ss = 0.f;
#pragma unroll
    for (int cb = 0; cb < 2; ++cb)
#pragma unroll
        for (int r = 0; r < 16; ++r) ss += acc[cb][r] * acc[cb][r];
    float rs = 1.f;
    if (T == 0 || T == 1 || T == 4 || T == 5) { ss += __shfl_xor(ss, 32); rs = __builtin_amdgcn_rsqf(ss * (1.f / 64.f) + EPS); }
#pragma unroll
    for (int cb = 0; cb < 2; ++cb)
#pragma unroll
        for (int s = 0; s < 2; ++s) { float v[8];
#pragma unroll
            for (int e = 0; e < 8; ++e) v[e] = acc[cb][8 * s + e];
            emit8<T, true>(C, row, gl, 4 * cb + 2 * s + hi, v, rs); }
}

__device__ __forceinline__ void tr_item(const float* W, int K, int N, bf16_t* WT, bool perm, LAS float* scr, int item, int lane) {
    const int nblk = N / 32, kb = item / nblk, nb = item % nblk, k0 = 64 * kb, n0 = 32 * nb;
#pragma unroll 8
    for (int i = 0; i < 32; ++i) { const int kk = 2 * i + (lane >> 5); scr[kk * 33 + (lane & 31)] = W[(size_t)(k0 + kk) * N + n0 + (lane & 31)]; }
    LDS_WAIT(); asm volatile("" ::: "memory");
    int ns0 = n0; if (perm) { const int co = n0 & 255; ns0 = (n0 & ~255) + 128 * ((co >> 5) & 1) + 32 * (co >> 6); }
    const int c = lane & 7;
#pragma unroll
    for (int j = 0; j < 4; ++j) { const int n = (lane >> 3) + 8 * j; const LAS float* s = scr + (8 * c) * 33 + n;
        u32x4 o; o.x = pk2(s[0 * 33], s[1 * 33]); o.y = pk2(s[2 * 33], s[3 * 33]); o.z = pk2(s[4 * 33], s[5 * 33]); o.w = pk2(s[6 * 33], s[7 * 33]);
        *(u32x4*)(WT + (size_t)(ns0 + n) * K + k0 + 8 * c) = o; }
    LDS_WAIT(); asm volatile("" ::: "memory");
}
__device__ __forceinline__ void mod_item(const Ctx& C, LAS float* sc, int item, int lane) {
    const int cg = item % 48, ks = item / 48;
    for (int i = lane; i < 2560; i += 64) { const int r = i >> 8, k = i & 255; const float c = (r < 2) ? C.cp[r * 1024 + ks * 256 + k] : C.cs[(r - 2) * 1024 + ks * 256 + k]; sc[i] = siluf_(c); }
    LDS_WAIT(); asm volatile("" ::: "memory");
    const int col = cg * 64 + lane; float acc[10];
#pragma unroll
    for (int r = 0; r < 10; ++r) acc[r] = 0.f;
    const float* w = C.w_ada + (size_t)(ks * 256) * 3072 + col;
#pragma unroll 2
    for (int k4 = 0; k4 < 64; ++k4) {
        const float w0 = w[(size_t)(4 * k4 + 0) * 3072], w1 = w[(size_t)(4 * k4 + 1) * 3072], w2 = w[(size_t)(4 * k4 + 2) * 3072], w3 = w[(size_t)(4 * k4 + 3) * 3072];
#pragma unroll
        for (int r = 0; r < 10; ++r) { const f32x4 s = *(const LAS f32x4*)(sc + r * 256 + 4 * k4); acc[r] += (s[0] * w0 + s[1] * w1) + (s[2] * w2 + s[3] * w3); }
    }
    float* MODP = (float*)(C.ws + WS_MODP);
#pragma unroll
    for (int r = 0; r < 10; ++r) MODP[(size_t)(ks * 10 + r) * 3072 + col] = acc[r];
    LDS_WAIT(); asm volatile("" ::: "memory");
}
__device__ __forceinline__ void p0_phase(const Ctx& C, LAS unsigned char* lds) {
    LAS float* scr = (LAS float*)(lds + RING_OFF + C.wave * 16384);
    const int lane = C.lane, gw = C.wave * C.G + C.bx, NGW = C.G * NWAVES;
    constexpr int I_MOD = 192, I_WIN = 16 * 192, I_WOA = 8 * 32, I_WOB = 8 * 32, I_WOUT = 16 * 32, I_CAK = 8192, I_CBK = 4096, I_CAV = 8192, I_CBV = 4096, I_PA = 32, I_PB = 64;
    constexpr int NITEMS = I_MOD + I_WIN + I_WOA + I_WOB + I_WOUT + I_CAK + I_CBK + I_CAV + I_CBV + I_PA + I_PB;
    for (int it = gw; it < NITEMS; it += NGW) {
        int r = it;
        if (r < I_MOD) { mod_item(C, scr, r, lane); continue; } r -= I_MOD;
        if (r < I_WIN) { tr_item(C.w_in, 1024, 6144, (bf16_t*)(C.ws + WS_WIN), true, scr, r, lane); continue; } r -= I_WIN;
        if (r < I_WOA) { tr_item(C.w_oa, 512, 1024, (bf16_t*)(C.ws + WS_WOA), false, scr, r, lane); continue; } r -= I_WOA;
        if (r < I_WOB) { tr_item(C.w_ob, 512, 1024, (bf16_t*)(C.ws + WS_WOB), false, scr, r, lane); continue; } r -= I_WOB;
        if (r < I_WOUT) { tr_item(C.w_out, 1024, 1024, (bf16_t*)(C.ws + WS_WOUT), false, scr, r, lane); continue; } r -= I_WOUT;
        if (r < I_CAK) {
            const int bs = r >> 10, s = r & 1023; const float* src = C.cak + (size_t)r * 512 + 8 * lane;
            const f32x4 a = *(const f32x4*)src, b = *(const f32x4*)(src + 4); const float v[8] = {a[0], a[1], a[2], a[3], b[0], b[1], b[2], b[3]};
            const int h = lane >> 4, mp = (lane >> 3) & 1, ch = lane & 7;
            *(u32x4*)(C.ws + WS_RAS + (size_t)((bs * 4 + h) * 17 + (s >> 6)) * RECA + mp * 8192 + ch * 1024 + (s & 63) * 16) = pack8(v); continue; } r -= I_CAK;
        if (r < I_CBK) {
            const int bs = r >> 9, s = r & 511; const float* src = C.cbk + (size_t)r * 512 + 8 * lane;
            const f32x4 a = *(const f32x4*)src, b = *(const f32x4*)(src + 4); const float v[8] = {a[0], a[1], a[2], a[3], b[0], b[1], b[2], b[3]};
            const int hb = lane >> 3, ch = lane & 7;
            *(u32x4*)(C.ws + WS_RBS + (size_t)((bs * 8 + hb) * 9 + (s >> 6)) * RECB + ch * 1024 + (s & 63) * 16) = pack8(v); continue; } r -= I_CBK;
        if (r < I_CAV) {
            const int dh = r & 1, h = (r >> 1) & 3, sb = (r >> 3) & 127, bs = r >> 10; const int d = dh * 64 + lane; float v[8];
#pragma unroll
            for (int e = 0; e < 8; ++e) v[e] = C.cav[((size_t)(bs * 1024 + sb * 8 + e) * 4 + h) * 128 + d];
            *(u32x4*)(C.ws + WS_RAS + (size_t)((bs * 4 + h) * 17 + (sb >> 3)) * RECA + 16384 + (sb & 7) * 2048 + d * 16) = pack8(v); continue; } r -= I_CAV;
        if (r < I_CBV) {
            const int hb = r & 7, sb = (r >> 3) & 63, bs = r >> 9; const int d = lane; float v[8];
#pragma unroll
            for (int e = 0; e < 8; ++e) v[e] = C.cbv[((size_t)(bs * 512 + sb * 8 + e) * 8 + hb) * 64 + d];
            *(u32x4*)(C.ws + WS_RBS + (size_t)((bs * 8 + hb) * 9 + (sb >> 3)) * RECB + 8192 + (sb & 7) * 1024 + d * 16) = pack8(v); continue; } r -= I_CBV;
        const u32x4 z = {0u, 0u, 0u, 0u};
        if (r < I_PA) {
            unsigned char* rec = C.ws + WS_RAS + (size_t)(r * 17 + 16) * RECA;
#pragma unroll
            for (int i = 0; i < 8; ++i) { const int idx = i * 64 + lane, seg = idx >> 5; *(u32x4*)(rec + (seg >> 3) * 8192 + (seg & 7) * 1024 + 512 + (idx & 31) * 16) = z; *(u32x4*)(rec + 16384 + 8192 + idx * 16) = z; }
            continue; } r -= I_PA;
        { unsigned char* rec = C.ws + WS_RBS + (size_t)(r * 9 + 8) * RECB;
#pragma unroll
            for (int i = 0; i < 4; ++i) { const int idx = i * 64 + lane, seg = idx >> 5; *(u32x4*)(rec + seg * 1024 + 512 + (idx & 31) * 16) = z; *(u32x4*)(rec + 8192 + 4096 + idx * 16) = z; } }
    }
}

__device__ __forceinline__ float wave_sum(float v) {
#pragma unroll
    for (int o = 1; o < 64; o <<= 1) v += __shfl_xor(v, o);
    return v;
}
__device__ __forceinline__ f32x4 mod_col4(const Ctx& C, int bidx, int col) {
    const float* MODP = (const float*)(C.ws + WS_MODP);
    f32x4 a = *(const f32x4*)(C.b_ada + col);
#pragma unroll
    for (int ks = 0; ks < 4; ++ks) a = a + *(const f32x4*)(MODP + (size_t)(ks * 10 + bidx) * 3072 + col);
    return a;
}
__device__ __forceinline__ void h_rows(const Ctx& C, int bidx, const float* x0, bf16_t* o0, int nrows) {
    const int lane = C.lane; f32x4 A[4], SH[4];
#pragma unroll
    for (int j = 0; j < 4; ++j) { const int c = 4 * lane + 256 * j; SH[j] = mod_col4(C, bidx, c); const f32x4 sc = mod_col4(C, bidx, 1024 + c); A[j] = *(const f32x4*)(C.g_norm + c) * (sc + 1.0f); }
    for (int rr = 0; rr < nrows; ++rr) {
        const f32x4* xr = (const f32x4*)(x0 + (size_t)rr * 1024) + lane; f32x4 v[4]; float s = 0.f;
#pragma unroll
        for (int j = 0; j < 4; ++j) { v[j] = xr[64 * j]; s += (v[j][0] * v[j][0] + v[j][1] * v[j][1]) + (v[j][2] * v[j][2] + v[j][3] * v[j][3]); }
        const float rstd = __builtin_amdgcn_rsqf(wave_sum(s) * (1.f / 1024.f) + EPS);
        u32x2* o8 = (u32x2*)(o0 + (size_t)rr * 1024) + lane;
#pragma unroll
        for (int j = 0; j < 4; ++j) { const f32x4 h = v[j] * rstd * A[j] + SH[j]; u32x2 w; w.x = pk2(h[0], h[1]); w.y = pk2(h[2], h[3]); o8[64 * j] = w; }
    }
}
__device__ __forceinline__ void p1_phase(const Ctx& C) {
    const int gw = C.wave * C.G + C.bx, NGW = C.G * NWAVES; bf16_t* XN = (bf16_t*)(C.ws + WS_XN);
    for (int it = gw; it < 2048; it += NGW) h_rows(C, (it * 8) >> 13, C.xp + (size_t)it * 8 * 1024, XN + (size_t)it * 8 * 1024, 8);
    for (int it = gw; it < 256; it += NGW) h_rows(C, 2 + (it >> 5), C.xs + (size_t)it * 1024, XN + (size_t)(MP + it) * 1024, 1);
    for (int it = gw; it < 10 * 12; it += NGW) { const int bidx = it / 12, c = (it % 12) * 256 + 4 * C.lane; *(f32x4*)((float*)(C.ws + WS_MODF) + bidx * 3072 + c) = mod_col4(C, bidx, c); }
}

__device__ __forceinline__ void p2_sample(const Ctx& C) {
    const int gw = C.wave * C.G + C.bx, NGW = C.G * NWAVES, lane = C.lane, hi = lane >> 5;
    for (int it = gw; it < 8 * 96; it += NGW) {
        const int rb = it / 96, G = it % 96; f32x16 acc[2]; acc[0] = f32x16{}; acc[1] = f32x16{};
        const bf16_t* A = (const bf16_t*)(C.ws + WS_XN) + (size_t)(MP + 32 * rb) * 1024;
        const bf16_t* B0 = (const bf16_t*)(C.ws + WS_WIN) + (size_t)(256 * (G >> 2) + 32 * (G & 3)) * 1024;
        wave_gemm32x64(A, 1024, B0, B0 + (size_t)128 * 1024, 1024, 1024, acc, lane);
        const int row = MP + 32 * rb + (lane & 31), sec = G >> 3, gl = G & 7;
        switch (sec) {
            case 0: smp_inproj_epi<0>(C, acc, row, gl, hi); break;
            case 1: smp_inproj_epi<1>(C, acc, row, gl, hi); break;
            case 2: smp_inproj_epi<2>(C, acc, row, gl, hi); break;
            case 3: smp_inproj_epi<3>(C, acc, row, gl, hi); break;
            case 4: smp_inproj_epi<4>(C, acc, row, gl, hi); break;
            case 5: smp_inproj_epi<5>(C, acc, row, gl, hi); break;
            case 6: smp_inproj_epi<6>(C, acc, row, gl, hi); break;
            case 7: smp_inproj_epi<7>(C, acc, row, gl, hi); break;
            default: smp_inproj_epi<8>(C, acc, row, G - 64, hi); break;
        }
    }
}
__device__ __forceinline__ void p4_sample(const Ctx& C) {
    const int gw = C.wave * C.G + C.bx, NGW = C.G * NWAVES, lane = C.lane, hi = lane >> 5;
    for (int it = gw; it < 8 * 16; it += NGW) {
        const int rb = it >> 4, cg = it & 15; f32x16 aa[2], ab[2]; aa[0] = f32x16{}; aa[1] = f32x16{}; ab[0] = f32x16{}; ab[1] = f32x16{};
        const size_t row0 = MP + 32 * rb;
        const bf16_t* BA = (const bf16_t*)(C.ws + WS_WOA) + (size_t)(64 * cg) * 512; const bf16_t* BB = (const bf16_t*)(C.ws + WS_WOB) + (size_t)(64 * cg) * 512;
        wave_gemm32x64((const bf16_t*)(C.ws + WS_OGA) + row0 * 512, 512, BA, BA + 32 * 512, 512, 512, aa, lane);
        wave_gemm32x64((const bf16_t*)(C.ws + WS_OGB) + row0 * 512, 512, BB, BB + 32 * 512, 512, 512, ab, lane);
        const int rs = 32 * rb + (lane & 31); const bf16_t* MG = (const bf16_t*)(C.ws + WS_MGS) + (size_t)rs * 2048; bf16_t* MTp = (bf16_t*)(C.ws + WS_MT) + (row0 + (lane & 31)) * 1024;
#pragma unroll
        for (int cb = 0; cb < 2; ++cb)
#pragma unroll
            for (int s = 0; s < 2; ++s) { const int col = 64 * cg + 32 * cb + 16 * s + 8 * hi; float ga[8], gb[8], v[8];
                unpack8(*(const u32x4*)(MG + col), ga); unpack8(*(const u32x4*)(MG + 1024 + col), gb);
#pragma unroll
                for (int e = 0; e < 8; ++e) v[e] = ga[e] * aa[cb][8 * s + e] + gb[e] * ab[cb][8 * s + e];
                *(u32x4*)(MTp + col) = pack8(v); }
    }
}
__device__ __forceinline__ void p5_sample(const Ctx& C) {
    const int gw = C.wave * C.G + C.bx, NGW = C.G * NWAVES, lane = C.lane, hi = lane >> 5;
    for (int it = gw; it < 8 * 16; it += NGW) {
        const int rb = it >> 4, cg = it & 15; f32x16 acc[2]; acc[0] = f32x16{}; acc[1] = f32x16{};
        const size_t row0 = MP + 32 * rb; const bf16_t* B0 = (const bf16_t*)(C.ws + WS_WOUT) + (size_t)(64 * cg) * 1024;
        wave_gemm32x64((const bf16_t*)(C.ws + WS_MT) + row0 * 1024, 1024, B0, B0 + 32 * 1024, 1024, 1024, acc, lane);
        const int rs = 32 * rb + (lane & 31); const float* gate = (const float*)(C.ws + WS_MODF) + (2 + rb) * 3072 + 2048;
#pragma unroll
        for (int cb = 0; cb < 2; ++cb)
#pragma unroll
            for (int s = 0; s < 2; ++s) { const int col = 64 * cg + 32 * cb + 16 * s + 8 * hi;
#pragma unroll
                for (int n = 0; n < 2; ++n) { const f32x4 gt = *(const f32x4*)(gate + col + 4 * n), xv = *(const f32x4*)(C.xs + (size_t)rs * 1024 + col + 4 * n);
                    const f32x4 a = {acc[cb][8 * s + 4 * n], acc[cb][8 * s + 4 * n + 1], acc[cb][8 * s + 4 * n + 2], acc[cb][8 * s + 4 * n + 3]};
                    *(f32x4*)(C.out + O_YS + (size_t)rs * 1024 + col + 4 * n) = xv + gt * a; } }
    }
}

template <int NK, int DV>
__device__ __forceinline__ void attn_run(LAS unsigned char* ring, const unsigned char* rec0, int t_lo, int t_hi, bool on, int wt_lo, int wt_hi, int kmap,
                                         const bf16x8 (&q)[4], int qpos0, int kpos_base, const LAS float* tab, int rel_lo, int rel_hi, int near_thr, float cfar, float cnear, bool half_last,
                                         f32x16 (&o)[DV / 32], float& lsum, int tid, int lane) {
    constexpr int REC = NK * 8192 + DV * 128, NCH = REC / 8192, ND = DV / 32;
    const int hi = lane >> 5, r32 = lane & 31, pr = (r32 & ~12) | ((r32 & 4) << 1) | ((r32 & 8) >> 1);
    u32x4 st[NCH];
    { const u32x4* g = (const u32x4*)(rec0 + (size_t)t_lo * REC) + tid;
#pragma unroll
      for (int i = 0; i < NCH; ++i) st[i] = g[i * 512]; }
    { LAS u32x4* d = (LAS u32x4*)ring + tid;
#pragma unroll
      for (int i = 0; i < NCH; ++i) d[i * 512] = st[i]; }
    if (t_lo + 1 < t_hi) { const u32x4* g = (const u32x4*)(rec0 + (size_t)(t_lo + 1) * REC) + tid;
#pragma unroll
      for (int i = 0; i < NCH; ++i) st[i] = g[i * 512]; }
    __syncthreads();
    for (int t = t_lo; t < t_hi; ++t) {
        const int cur = (t - t_lo) & 1;
        LAS unsigned char* stage = ring + cur * REC;
        if (t + 1 < t_hi) { LAS u32x4* d = (LAS u32x4*)(ring + (cur ^ 1) * REC) + tid;
#pragma unroll
            for (int i = 0; i < NCH; ++i) d[i * 512] = st[i]; }
        if (t + 2 < t_hi) { const u32x4* g = (const u32x4*)(rec0 + (size_t)(t + 2) * REC) + tid;
#pragma unroll
            for (int i = 0; i < NCH; ++i) st[i] = g[i * 512]; }
        if (on && t >= wt_lo && t <= wt_hi) {
            const int kpos0 = kpos_base + 64 * t;
            const bool nearb = (qpos0 - (kpos0 + 63)) < near_thr;
            const float c0 = nearb ? cnear : cfar;
            f32x16 p0, p1;
#pragma unroll
            for (int r = 0; r < 16; ++r) { p0[r] = c0; p1[r] = c0; }
            const LAS unsigned char* kt = stage + kmap * 8192 + pr * 16 + hi * 1024;
            __builtin_amdgcn_sched_barrier(0);
#pragma unroll
            for (int ds = 0; ds < 4; ++ds) {
                const bf16x8 a0 = *(const LAS bf16x8*)(kt + ds * 2048), a1 = *(const LAS bf16x8*)(kt + ds * 2048 + 512);
                p0 = __builtin_amdgcn_mfma_f32_32x32x16_bf16(a0, q[ds], p0, 0, 0, 0);
                p1 = __builtin_amdgcn_mfma_f32_32x32x16_bf16(a1, q[ds], p1, 0, 0, 0);
            }
            __builtin_amdgcn_sched_barrier(0);
            if (nearb) {
                const int base = kpos0 + 8 * hi - (qpos0 + r32);
#pragma unroll
                for (int r = 0; r < 16; ++r) {
                    const int rel = base + 16 * (r >> 3) + (r & 7);
                    const int i0 = min(max(rel, rel_lo), rel_hi) - rel_lo, i1 = min(max(rel + 32, rel_lo), rel_hi) - rel_lo;
                    p0[r] += tab[i0]; p1[r] += tab[i1];
                }
            }
            float sacc = 0.f;
#pragma unroll
            for (int r = 0; r < 16; ++r) { p0[r] = __builtin_amdgcn_exp2f(p0[r]); p1[r] = __builtin_amdgcn_exp2f(p1[r]); }
            if (half_last && t == t_hi - 1) {
#pragma unroll
                for (int r = 0; r < 16; ++r) p1[r] = 0.f;
            }
#pragma unroll
            for (int r = 0; r < 16; ++r) sacc += p0[r] + p1[r];
            lsum += sacc;
            bf16x8 pw[4];
            { u32x4 w;
              w.x = pk2(p0[0], p0[1]); w.y = pk2(p0[2], p0[3]); w.z = pk2(p0[4], p0[5]); w.w = pk2(p0[6], p0[7]); pw[0] = __builtin_bit_cast(bf16x8, w);
              w.x = pk2(p0[8], p0[9]); w.y = pk2(p0[10], p0[11]); w.z = pk2(p0[12], p0[13]); w.w = pk2(p0[14], p0[15]); pw[1] = __builtin_bit_cast(bf16x8, w);
              w.x = pk2(p1[0], p1[1]); w.y = pk2(p1[2], p1[3]); w.z = pk2(p1[4], p1[5]); w.w = pk2(p1[6], p1[7]); pw[2] = __builtin_bit_cast(bf16x8, w);
              w.x = pk2(p1[8], p1[9]); w.y = pk2(p1[10], p1[11]); w.z = pk2(p1[12], p1[13]); w.w = pk2(p1[14], p1[15]); pw[3] = __builtin_bit_cast(bf16x8, w); }
            const LAS unsigned char* vt = stage + NK * 8192 + r32 * 16 + hi * (DV * 16);
            __builtin_amdgcn_sched_barrier(0);
#pragma unroll
            for (int d0 = 0; d0 < ND; ++d0) {
#pragma unroll
                for (int ks = 0; ks < 4; ++ks) {
                    const bf16x8 bv = *(const LAS bf16x8*)(vt + ks * (2 * DV * 16) + d0 * 512);
                    o[d0] = __builtin_amdgcn_mfma_f32_32x32x16_bf16(pw[ks], bv, o[d0], 0, 0, 0);
                }
                __builtin_amdgcn_sched_barrier(0);
            }
        }
        __syncthreads();
    }
}

__device__ __forceinline__ int t5_bucket_abs(int n) { return n < 8 ? n : 8 + (n >= 12) + (n >= 16) + (n >= 23) + (n >= 32) + (n >= 46) + (n >= 64) + (n >= 91); }

__device__ __forceinline__ void unitA(const Ctx& C, LAS unsigned char* lds, bool smp, int b, int h, int qb) {
    const int tid = C.tid, lane = C.lane, w = C.wave, hi = lane >> 5, r32 = lane & 31, mp = w >> 2, qs = w & 3;
    LAS float* tab = (LAS float*)(lds + TAB_OFF);
    if (tid < 155) { const int rel = tid - 91; const int n = rel < 0 ? -rel : rel; const int bk = (rel > 0 ? 16 : 0) + t5_bucket_abs(n); tab[tid] = C.t5[bk * 4 + h] * LOG2E; }
    float mq = fabsf(C.g_qa[lane]), mk = fabsf(C.g_ka[lane]), mb = (lane < 32) ? fabsf(C.t5[lane * 4 + h]) : 0.f;
#pragma unroll
    for (int o = 1; o < 64; o <<= 1) { mq = fmaxf(mq, __shfl_xor(mq, o)); mk = fmaxf(mk, __shfl_xor(mk, o)); mb = fmaxf(mb, __shfl_xor(mb, o)); }
    const float Msh = 8.f * mq * mk * 1.01f + mb;
    const float lam = __expf(wave_sum(C.lq1[lane] * C.lk1[lane])) - __expf(wave_sum(C.lq2[lane] * C.lk2[lane])) + LAM_INIT;
    const float cfar = (C.t5[15 * 4 + h] - Msh) * LOG2E, cnear = -Msh * LOG2E;
    const bool on = smp ? (qs == 0) : true;
    const int row_w = smp ? (MP + 32 * b) : (b * SEQ + 128 * qb + 32 * qs);
    const int qpos0 = smp ? 1024 : (128 * qb + 32 * qs);
    const int t_hi = smp ? 17 : (2 * qb + 2);
    const int wt_hi = smp ? 16 : (2 * qb + (qs >> 1));
    const unsigned char* rec0 = smp ? C.ws + WS_RAS + (size_t)((b * 4 + h) * 17) * RECA : C.ws + WS_RAP + (size_t)((b * 4 + h) * 128) * RECA;
    bf16x8 q[4];
    { const bf16_t* qp = (const bf16_t*)(C.ws + WS_Q) + (size_t)(row_w + r32) * 1024 + h * 128 + mp * 64 + 8 * hi;
#pragma unroll
      for (int ds = 0; ds < 4; ++ds) q[ds] = on ? *(const bf16x8*)(qp + 16 * ds) : bf16x8{}; }
    f32x16 o[4]; o[0] = f32x16{}; o[1] = f32x16{}; o[2] = f32x16{}; o[3] = f32x16{};
    float lsum = 0.f;
    attn_run<2, 128>(lds, rec0, 0, t_hi, on, 0, wt_hi, mp, q, qpos0, 0, tab, -91, 63, 91, cfar, cnear, smp, o, lsum, tid, lane);
    const float lt = lsum + __shfl_xor(lsum, 32);
    const float inv = on ? __builtin_amdgcn_rcpf(lt) : 0.f;
    float invr[16];
#pragma unroll
    for (int r = 0; r < 16; ++r) invr[r] = __shfl(inv, crow(r, hi));
    LAS float* ex = (LAS float*)lds + (size_t)qs * 4096 + lane;
    if (on && mp == 1) {
#pragma unroll
        for (int d0 = 0; d0 < 4; ++d0)
#pragma unroll
            for (int r = 0; r < 16; ++r) ex[(d0 * 16 + r) * 64] = o[d0][r] * invr[r] * lam;
    }
    __syncthreads();
    if (on && mp == 0) {
        float ss[16];
#pragma unroll
        for (int r = 0; r < 16; ++r) { float s = 0.f;
#pragma unroll
            for (int d0 = 0; d0 < 4; ++d0) { const float v = o[d0][r] * invr[r] - ex[(d0 * 16 + r) * 64]; o[d0][r] = v; s += v * v; }
            ss[r] = s; }
#pragma unroll
        for (int r = 0; r < 16; ++r) {
#pragma unroll
            for (int x = 1; x < 32; x <<= 1) ss[r] += __shfl_xor(ss[r], x);
            ss[r] = __builtin_amdgcn_rsqf(ss[r] * (1.f / 128.f) + EPS) * (1.f - LAM_INIT);
        }
        const bf16_t* GA = (const bf16_t*)(C.ws + WS_G); bf16_t* OGA = (bf16_t*)(C.ws + WS_OGA);
#pragma unroll
        for (int d0 = 0; d0 < 4; ++d0) { const int d = 32 * d0 + r32; const float gs = C.g_sub[d];
#pragma unroll
            for (int r = 0; r < 16; ++r) { const size_t row = (size_t)row_w + crow(r, hi);
                const float ga = bf2f(GA[row * 1024 + h * 128 + d]);
                OGA[row * 512 + h * 128 + d] = f2bf(o[d0][r] * ss[r] * gs * ga); } }
    }
    __syncthreads();
}
__device__ __forceinline__ void unitB(const Ctx& C, LAS unsigned char* lds, bool smp, int b, int hb, int qb) {
    const int tid = C.tid, lane = C.lane, w = C.wave, hi = lane >> 5, r32 = lane & 31;
    LAS float* tab = (LAS float*)(lds + TAB_OFF);
    if (tid < 192) tab[tid] = C.relb[tid * 8 + hb] * LOG2E;
    float mq = fabsf(C.g_qb[lane]), mk = fabsf(C.g_kb[lane]), mb = 0.f;
    for (int i = lane; i < 257; i += 64) mb = fmaxf(mb, fabsf(C.relb[i * 8 + hb]));
#pragma unroll
    for (int o = 1; o < 64; o <<= 1) { mq = fmaxf(mq, __shfl_xor(mq, o)); mk = fmaxf(mk, __shfl_xor(mk, o)); mb = fmaxf(mb, __shfl_xor(mb, o)); }
    const float Msh = 8.f * mq * mk * 1.01f + mb;
    const float cfar = (C.relb[hb] - Msh) * LOG2E, cnear = -Msh * LOG2E;
    const bool on = smp ? (w == 0) : true;
    const int row_w = smp ? (MP + 32 * b) : (b * SEQ + 256 * qb + 32 * w);
    const int qpos0 = smp ? 1024 : (256 * qb + 32 * w);
    const int cw = 4 * qb + (w >> 1);
    const int t_lo = smp ? 0 : max(0, 4 * qb - 8), t_hi = smp ? 9 : (4 * qb + 4);
    const int wt_lo = smp ? 0 : max(0, cw - 8), wt_hi = smp ? 8 : cw;
    const unsigned char* rec0 = smp ? C.ws + WS_RBS + (size_t)((b * 8 + hb) * 9) * RECB : C.ws + WS_RBP + (size_t)((b * 8 + hb) * 128) * RECB;
    bf16x8 q[4];
    { const bf16_t* qp = (const bf16_t*)(C.ws + WS_Q) + (size_t)(row_w + r32) * 1024 + 512 + hb * 64 + 8 * hi;
#pragma unroll
      for (int ds = 0; ds < 4; ++ds) q[ds] = on ? *(const bf16x8*)(qp + 16 * ds) : bf16x8{}; }
    f32x16 o[2]; o[0] = f32x16{}; o[1] = f32x16{};
    float lsum = 0.f;
    attn_run<1, 64>(lds, rec0, t_lo, t_hi, on, wt_lo, wt_hi, 0, q, qpos0, smp ? 512 : 0, tab, -128, 63, 128, cfar, cnear, smp, o, lsum, tid, lane);
    const float lt = lsum + __shfl_xor(lsum, 32);
    const float inv = on ? __builtin_amdgcn_rcpf(lt) : 0.f;
    if (on) {
        const bf16_t* GB = (const bf16_t*)(C.ws + WS_G); bf16_t* OGB = (bf16_t*)(C.ws + WS_OGB);
#pragma unroll
        for (int r = 0; r < 16; ++r) { const float ir = __shfl(inv, crow(r, hi)); const size_t row = (size_t)row_w + crow(r, hi);
#pragma unroll
            for (int d0 = 0; d0 < 2; ++d0) { const int d = 32 * d0 + r32; const float gb = bf2f(GB[row * 1024 + 512 + hb * 64 + d]);
                OGB[row * 512 + hb * 64 + d] = f2bf(o[d0][r] * ir * gb); } }
    }
}
__device__ __forceinline__ void p3_phase(const Ctx& C, LAS unsigned char* lds) {
    for (int vb = C.bx; vb < 256; vb += C.G) {
        const int vcu = (vb & 7) * 32 + (vb >> 3);
        for (int i = 0; i < 5; ++i) {
            bool isA, smp; int b, h, qb;
            if (i == 0) { if (vb >= 96) continue; smp = true; qb = 0; isA = vb < 32; if (isA) { b = vb >> 2; h = vb & 3; } else { b = (vb - 32) >> 3; h = (vb - 32) & 7; } }
            else if (i <= 2) { const int u = vcu + 256 * (i - 1); isA = false; smp = false; b = u >> 8; h = (u >> 5) & 7; qb = u & 31; }
            else { const int bh = vcu >> 5, p = vcu & 31; isA = true; smp = false; b = bh >> 2; h = bh & 3; qb = (i == 3) ? 63 - p : p; }
            if (isA) unitA(C, lds, smp, b, h, qb); else unitB(C, lds, smp, b, h, qb);
        }
    }
}
#define XB_TMO      128
#define XB_XCNT(j)  (256  + 64 * (j))
#define XB_XSUB(j)  (1280 + 64 * (j))
#define XB_XGEN(j)  (2304 + 64 * (j))
#define XB_TOP      3328
#define XB_TOPGEN   3392
#define XCD_BAR_WORDS 3456
#define XB_SPIN_CAP (1u << 18)

__device__ __forceinline__ unsigned xb_ld(unsigned* p)              { return __hip_atomic_load(p, __ATOMIC_RELAXED, __HIP_MEMORY_SCOPE_AGENT); }
__device__ __forceinline__ unsigned xb_add(unsigned* p, unsigned v) { return __hip_atomic_fetch_add(p, v, __ATOMIC_RELAXED, __HIP_MEMORY_SCOPE_AGENT); }
__device__ __forceinline__ unsigned xb_xcc_id() { return (unsigned)__builtin_amdgcn_s_getreg((3 << 11) | 20) & 0xFu; }
#define XB_SPIN(cond, bar) do { unsigned _sp = 0; while (cond) { __builtin_amdgcn_s_sleep(1); \
    if ((++_sp & 255u) == 0u) { if (xb_ld(&(bar)[XB_TMO])) break; if (_sp > XB_SPIN_CAP) { atomicAdd(&(bar)[XB_TMO], 1u); break; } } } } while (0)

struct XcdBarrier {
    unsigned* bar; unsigned x;
    volatile LAS unsigned* st;
};

__device__ __forceinline__ XcdBarrier xcd_barrier_post(unsigned* bar, volatile LAS unsigned* st) {
    XcdBarrier b; b.bar = bar; b.x = xb_xcc_id(); b.st = st;
    if (threadIdx.x == 0) (void)xb_add(&bar[XB_XCNT(b.x)], 1u);
    return b;
}
__device__ __forceinline__ void xcd_barrier_complete(unsigned* bar, unsigned x, unsigned& nloc, unsigned& nx) {
    const unsigned G = gridDim.x * gridDim.y * gridDim.z;
    unsigned sum, cnt, mine, sp = 0u;
    for (;;) {
        sum = 0u; cnt = 0u; mine = 0u;
#pragma unroll
        for (unsigned j = 0; j < 16; ++j) { const unsigned c = xb_ld(&bar[XB_XCNT(j)]); sum += c; cnt += (c > 0u) ? 1u : 0u; mine = (j == x) ? c : mine; }
        if (sum == G) break;
        __builtin_amdgcn_s_sleep(1);
        if ((++sp & 255u) == 0u) { if (xb_ld(&bar[XB_TMO])) break; if (sp > XB_SPIN_CAP) { atomicAdd(&bar[XB_TMO], 1u); break; } }
    }
    nloc = mine > 0u ? mine : 1u; nx = cnt > 0u ? cnt : 1u;
}

__device__ __forceinline__ void xcd_barrier(const XcdBarrier& b) {
    asm volatile("s_waitcnt vmcnt(0)" ::: "memory");
    __syncthreads();
    if (threadIdx.x == 0) {
        unsigned* bar = b.bar;
        __builtin_amdgcn_s_waitcnt(0);
        unsigned nloc = b.st[0], nx = b.st[1];
        if (nloc == 0u) { xcd_barrier_complete(bar, b.x, nloc, nx); b.st[0] = nloc; b.st[1] = nx; }
        const unsigned old = xb_add(&bar[XB_XSUB(b.x)], 1u);
        const unsigned gen = old / nloc;
        if (old + 1u == (gen + 1u) * nloc) {
            __builtin_amdgcn_fence(__ATOMIC_RELEASE, "agent");
            asm volatile("s_waitcnt vmcnt(0)" ::: "memory");
            const unsigned og = xb_add(&bar[XB_TOP], 1u);
            const unsigned tg = og / nx;
            if (og + 1u == (tg + 1u) * nx) xb_add(&bar[XB_TOPGEN], 1u);
            else XB_SPIN(xb_ld(&bar[XB_TOPGEN]) == tg, bar);
            __builtin_amdgcn_fence(__ATOMIC_ACQUIRE, "agent");
            xb_add(&bar[XB_XGEN(b.x)], 1u);
            asm volatile("s_waitcnt vmcnt(0)" ::: "memory");
        } else {
            XB_SPIN(xb_ld(&bar[XB_XGEN(b.x)]) == gen, bar);
            __builtin_amdgcn_fence(__ATOMIC_ACQUIRE, "agent");
            asm volatile("s_waitcnt vmcnt(0)" ::: "memory");
        }
    }
    __syncthreads();
}

#ifndef MK_N_LAUNCHES
#define MK_N_LAUNCHES 1
#endif
constexpr int N_LAUNCHES = MK_N_LAUNCHES;
struct Args { const float* in[26]; float* out; unsigned char* ws; int ph_lo, ph_hi; };
__global__ void __launch_bounds__(NWAVES * 64, 2) fwd_kernel(Args args) {
    extern __shared__ __attribute__((aligned(16))) unsigned char lds_raw[];
    LAS unsigned char* lds = (LAS unsigned char*)lds_raw;
    Ctx C;
    C.xp = args.in[0]; C.xs = args.in[1]; C.cak = args.in[2]; C.cav = args.in[3]; C.cbk = args.in[4]; C.cbv = args.in[5]; C.cp = args.in[6]; C.cs = args.in[7];
    C.g_norm = args.in[8]; C.w_ada = args.in[9]; C.b_ada = args.in[10]; C.w_in = args.in[11]; C.g_qa = args.in[12]; C.g_ka = args.in[13];
    C.lq1 = args.in[14]; C.lk1 = args.in[15]; C.lq2 = args.in[16]; C.lk2 = args.in[17]; C.g_sub = args.in[18]; C.t5 = args.in[19]; C.g_qb = args.in[20]; C.g_kb = args.in[21];
    C.relb = args.in[22]; C.w_oa = args.in[23]; C.w_ob = args.in[24]; C.w_out = args.in[25]; C.out = args.out; C.ws = args.ws;
    C.tid = threadIdx.x; C.lane = C.tid & 63; C.wave = __builtin_amdgcn_readfirstlane(C.tid >> 6);
    C.G = gridDim.x; C.bx = blockIdx.x; C.vcu = (C.G % 8 == 0) ? (C.bx % 8) * (C.G / 8) + C.bx / 8 : C.bx;
    volatile LAS unsigned* MISC = (volatile LAS unsigned*)(lds + MISC_OFF);
    for (int u = C.tid; u < (LDS_BYTES - RING_BYTES) / 4; u += NWAVES * 64) ((LAS unsigned*)(lds + RING_BYTES))[u] = 0u;
    __syncthreads();
    XcdBarrier bar; bar.bar = (unsigned*)(C.ws + WS_CTL) + CW_BAR; bar.x = 0; bar.st = nullptr;
    if (N_LAUNCHES == 1) bar = xcd_barrier_post((unsigned*)(C.ws + WS_CTL) + CW_BAR, MISC + 8);
    const int lo = args.ph_lo, hi = args.ph_hi;
#define IN(k) (lo <= (k) && (k) < hi)
#define SEAM(k) do { if (IN(k) && IN((k) + 1)) xcd_barrier(bar); } while (0)
    if (IN(0)) { p0_phase(C, lds); SEAM(0); }
    if (IN(1)) { p1_phase(C); SEAM(1); }
    if (IN(2)) {
        p2_sample(C);
        pg8::Gemm g{(const bf16_t*)(C.ws + WS_XN), (const bf16_t*)(C.ws + WS_WIN), MP, INC, 1024}; pg8::StaticOrder S; S.init(MP, INC, C.G, C.bx);
        EpiInProj E{C};
        pg8::gemm_phase<EpiInProj, pg8::StaticOrder, true, true>(lds + RING_OFF, g, S, E);
        SEAM(2);
    }
    if (IN(3)) { p3_phase(C, lds + RING_OFF); SEAM(3); }
    if (IN(4)) {
        p4_sample(C);
        { pg8::Gemm g{(const bf16_t*)(C.ws + WS_OGA), (const bf16_t*)(C.ws + WS_WOA), MP, 1024, 512}; pg8::StaticOrder S; S.init(MP, 1024, C.G, C.bx);
          EpiMerge<0> E{C}; pg8::gemm_phase<EpiMerge<0>, pg8::StaticOrder, true, true>(lds + RING_OFF, g, S, E); }
        { pg8::Gemm g{(const bf16_t*)(C.ws + WS_OGB), (const bf16_t*)(C.ws + WS_WOB), MP, 1024, 512}; pg8::StaticOrder S; S.init(MP, 1024, C.G, C.bx);
          EpiMerge<1> E{C}; pg8::gemm_phase<EpiMerge<1>, pg8::StaticOrder, true, true>(lds + RING_OFF, g, S, E); }
        SEAM(4);
    }
    if (IN(5)) {
        p5_sample(C);
        pg8::Gemm g{(const bf16_t*)(C.ws + WS_MT), (const bf16_t*)(C.ws + WS_WOUT), MP, 1024, 1024}; pg8::StaticOrder S; S.init(MP, 1024, C.G, C.bx);
        EpiFinal E{C}; pg8::gemm_phase<EpiFinal, pg8::StaticOrder, true, true>(lds + RING_OFF, g, S, E);
    }
#undef IN
#undef SEAM
}

extern "C" void kernel_launch(void* const* d_in, const int* in_sizes, int n_in, void* d_out, int out_size, void* d_ws, size_t ws_size, hipStream_t stream) {
    static int grid = 0;
    if (grid == 0) {
        if (n_in != 26 || ws_size < WS_END) { fprintf(stderr, "kernel_launch: unexpected shapes (n_in %d out %d ws %zu)\n", n_in, out_size, ws_size); grid = -1; return; }
        int dev = 0, cus = 0, per_cu = 0;
        if (hipGetDevice(&dev) != hipSuccess || hipDeviceGetAttribute(&cus, hipDeviceAttributeMultiprocessorCount, dev) != hipSuccess) { grid = -1; return; }
        if (hipFuncSetAttribute((const void*)fwd_kernel, hipFuncAttributeMaxDynamicSharedMemorySize, LDS_BYTES) != hipSuccess) { fprintf(stderr, "kernel_launch: hipFuncSetAttribute failed\n"); grid = -1; return; }
        if (hipOccupancyMaxActiveBlocksPerMultiprocessor(&per_cu, (const void*)fwd_kernel, NWAVES * 64, LDS_BYTES) != hipSuccess || per_cu < 1)
            fprintf(stderr, "kernel_launch: note: occupancy query reports %d workgroups per CU\n", per_cu);
        (void)hipGetLastError();
        grid = cus;
    }
    if (grid < 0) return;
    if (hipMemsetAsync((char*)d_ws + WS_CTL, 0, CTL_ZERO_BYTES, stream) != hipSuccess) { fprintf(stderr, "kernel_launch: memset failed\n"); return; }
    Args a{};
    for (int i = 0; i < 26; ++i) a.in[i] = (const float*)d_in[i];
    a.out = (float*)d_out; a.ws = (unsigned char*)d_ws;
    for (int li = 0; li < N_LAUNCHES; ++li) {
        a.ph_lo = (N_LAUNCHES == 1) ? 0 : li; a.ph_hi = (N_LAUNCHES == 1) ? 6 : li + 1;
        hipLaunchKernelGGL(fwd_kernel, dim3(grid), dim3(NWAVES * 64), LDS_BYTES, stream, a);
        const hipError_t le = hipPeekAtLastError();
        if (le != hipSuccess) { fprintf(stderr, "kernel_launch: launch %d failed: %s\n", li, hipGetErrorName(le)); break; }
    }
}
```
